# Optimizing an MI355X kernel written in HIP

```python
import jax, jax.numpy as jnp
from jax import lax
import numpy as np

D_MODEL = 1024
BATCH = 8
SEQ = 4096
DEPTH = 4

CHUNK = 64
N_A = DEPTH // 2
N_B = DEPTH - N_A
GMLP_BLOCK = 128
GMLP_WIDTH = D_MODEL
GMLP_GROUPS = 8
GMLP_GROUP_DIM = GMLP_WIDTH // GMLP_GROUPS
SB_HEADS = 16
SB_HEAD_DIM = D_MODEL // SB_HEADS
SB_QBLOCK = 128
D_FF = 4 * D_MODEL
ALPHA = float((2 * DEPTH) ** 0.25)
BETA = float((8 * DEPTH) ** -0.25)
LN_EPS = 1e-5

kernel_name = "yoco_gmlp_stickbreaking_deepnorm"


def layer_norm(x, g, b):
    xf = x.astype(jnp.float32)
    mu = jnp.mean(xf, axis=-1, keepdims=True)
    var = jnp.mean(jnp.square(xf - mu), axis=-1, keepdims=True)
    y = (xf - mu) * lax.rsqrt(var + LN_EPS) * g.astype(jnp.float32) + b.astype(jnp.float32)
    return y.astype(x.dtype)


def chunk_causal_mask(n):
    pos = jnp.arange(n)
    return (pos[None, :] // CHUNK) <= (pos[:, None] // CHUNK)


def gmlp_mixer(x, w_in, ln_g, ln_b, w_s, b_s, w_out):
    bsz, seq, _ = x.shape
    z = jax.nn.gelu(x @ w_in)
    u, v = jnp.split(z, 2, axis=-1)
    v = layer_norm(v, ln_g, ln_b)
    nblk = seq // GMLP_BLOCK
    v = v.reshape(bsz, nblk, GMLP_BLOCK, GMLP_GROUPS, GMLP_GROUP_DIM)
    ws = jnp.where(chunk_causal_mask(GMLP_BLOCK)[None], w_s, jnp.zeros((), w_s.dtype))
    s = jnp.einsum('gts,bnsgc->bntgc', ws, v)
    s = s + jnp.transpose(b_s)[None, None, :, :, None]
    s = s.reshape(bsz, seq, GMLP_WIDTH)
    return (u * s) @ w_out


def stick_breaking_mixer(x, w_q, w_o, k, v):
    bsz, seq, _ = x.shape
    q = (x @ w_q).reshape(bsz, seq, SB_HEADS, SB_HEAD_DIM).transpose(0, 2, 1, 3)
    scale = SB_HEAD_DIM ** -0.5
    outs = []
    for i in range(seq // SB_QBLOCK):
        q0, q1 = i * SB_QBLOCK, (i + 1) * SB_QBLOCK
        qb = q[:, :, q0:q1]
        kb = k[:, :, :q1]
        vb = v[:, :, :q1]
        zlog = jnp.einsum('bhtd,bhsd->bhts', qb, kb).astype(jnp.float32) * scale
        t_idx = q0 + jnp.arange(SB_QBLOCK)
        s_idx = jnp.arange(q1)
        causal = s_idx[None, :] < t_idx[:, None]
        log_rem = jnp.where(causal, jax.nn.log_sigmoid(-zlog), 0.0)
        excl = lax.cumsum(log_rem, axis=3, reverse=True) - log_rem
        log_a = jax.nn.log_sigmoid(zlog) + excl
        a = jnp.where(causal, jnp.exp(log_a), 0.0).astype(vb.dtype)
        outs.append(jnp.einsum('bhts,bhsd->bhtd', a, vb))
    o = jnp.concatenate(outs, axis=2)
    o = o.transpose(0, 2, 1, 3).reshape(bsz, seq, D_MODEL)
    return o @ w_o


def squared_relu_mlp(x, w1, w2):
    return jnp.square(jax.nn.relu(x @ w1)) @ w2


def setup_inputs(seed: int = 0) -> dict:
    key = jax.random.key(seed)
    ks = jax.random.split(key, 20)

    def nrm(k, shape, scale):
        return jax.random.normal(k, shape, jnp.float32) * scale

    return {
        "x": nrm(ks[0], (BATCH, SEQ, D_MODEL), 1.0),
        "a_w_in": nrm(ks[1], (N_A, D_MODEL, 2 * GMLP_WIDTH), D_MODEL ** -0.5),
        "a_ln_g": 1.0 + nrm(ks[2], (N_A, GMLP_WIDTH), 0.02),
        "a_ln_b": nrm(ks[3], (N_A, GMLP_WIDTH), 0.02),
        "a_w_s": nrm(ks[4], (N_A, GMLP_GROUPS, GMLP_BLOCK, GMLP_BLOCK), GMLP_BLOCK ** -0.5),
        "a_b_s": 1.0 + nrm(ks[5], (N_A, GMLP_GROUPS, GMLP_BLOCK), 0.02),
        "a_w_out": nrm(ks[6], (N_A, GMLP_WIDTH, D_MODEL), BETA * GMLP_WIDTH ** -0.5),
        "sb_w_k": nrm(ks[7], (D_MODEL, D_MODEL), D_MODEL ** -0.5),
        "sb_w_v": nrm(ks[8], (D_MODEL, D_MODEL), BETA * D_MODEL ** -0.5),
        "b_w_q": nrm(ks[9], (N_B, D_MODEL, D_MODEL), D_MODEL ** -0.5),
        "b_w_o": nrm(ks[10], (N_B, D_MODEL, D_MODEL), BETA * D_MODEL ** -0.5),
        "mix_ln_g": 1.0 + nrm(ks[11], (DEPTH, D_MODEL), 0.02),
        "mix_ln_b": nrm(ks[12], (DEPTH, D_MODEL), 0.02),
        "ffn_ln_g": 1.0 + nrm(ks[13], (DEPTH, D_MODEL), 0.02),
        "ffn_ln_b": nrm(ks[14], (DEPTH, D_MODEL), 0.02),
        "ffn_w1": nrm(ks[15], (DEPTH, D_MODEL, D_FF), BETA * D_MODEL ** -0.5),
        "ffn_w2": nrm(ks[16], (DEPTH, D_FF, D_MODEL), BETA * D_FF ** -0.5),
    }


def reference(x, a_w_in, a_ln_g, a_ln_b, a_w_s, a_b_s, a_w_out, sb_w_k, sb_w_v,
              b_w_q, b_w_o, mix_ln_g, mix_ln_b, ffn_ln_g, ffn_ln_b, ffn_w1, ffn_w2):
    bsz, seq, _ = x.shape
    k_shared = None
    v_shared = None
    for l in range(DEPTH):
        if l < N_A:
            mix = gmlp_mixer(x, a_w_in[l], a_ln_g[l], a_ln_b[l], a_w_s[l], a_b_s[l], a_w_out[l])
        else:
            if l == N_A:
                k_shared = (x @ sb_w_k).reshape(bsz, seq, SB_HEADS, SB_HEAD_DIM).transpose(0, 2, 1, 3)
                v_shared = (x @ sb_w_v).reshape(bsz, seq, SB_HEADS, SB_HEAD_DIM).transpose(0, 2, 1, 3)
            j = l - N_A
            mix = stick_breaking_mixer(x, b_w_q[j], b_w_o[j], k_shared, v_shared)
        x = layer_norm(ALPHA * x + mix, mix_ln_g[l], mix_ln_b[l])
        x = layer_norm(ALPHA * x + squared_relu_mlp(x, ffn_w1[l], ffn_w2[l]), ffn_ln_g[l], ffn_ln_b[l])
    return x
```

```cpp
#include <hip/hip_runtime.h>
#include <hip/hip_cooperative_groups.h>
#include <cstdio>
#include <cstdint>
namespace cg = cooperative_groups;
namespace pg8 {
#define PG8_LAS __attribute__((address_space(3)))
typedef unsigned short bf16_t;
typedef short bf16x8 __attribute__((ext_vector_type(8)));
typedef float f32x4 __attribute__((ext_vector_type(4)));
typedef unsigned u32x4 __attribute__((ext_vector_type(4)));
constexpr int BM = 256, BK = 64, HALF = 128, HTB = HALF * BK * 2  , STAGE_BYTES = 8 * HTB, NXCD = 8, WGM = 8;

__host__ __device__ __forceinline__ int lds_byte(int r, int c) { const int st = (r >> 4) * 2 + (c >> 5), rr = r & 15, cc = c & 31, ob = rr * 64 + cc * 2; return st * 1024 + (ob ^ (((ob >> 9) & 1) << 5)); }
__host__ __device__ __forceinline__ void stage_rc(int b, int& R, int& C) { const int st = b / 1024, sb = b % 1024, swz = sb ^ (((sb >> 9) & 1) << 5); R = (st >> 1) * 16 + swz / 64; C = (st & 1) * 32 + (swz % 64) / 2; }
__host__ __device__ __forceinline__ int perm32(int rho) { const int n = rho >> 4, i = rho & 15; return 8 * (i >> 2) + 4 * n + (i & 3); }

struct Unit { int pm, pn; };
struct Gemm { const bf16_t* A; const bf16_t* Bt; int M, N, K; };

struct StaticOrder {
    int nM, nN, nwg, G, c;
    __host__ __device__ void init(int M, int N, int G_, int c_) { nM = M / BM; nN = N / BM; nwg = nM * nN; G = G_; c = c_; }
    __host__ __device__ bool next(int i, Unit& u) const {
        const long L = (long)i * G + c; if (L >= nwg) return false;
        int wgid = (int)L; { const int q = nwg / NXCD, r = nwg % NXCD, xcd = wgid % NXCD, off = wgid / NXCD; wgid = (xcd < r ? xcd * (q + 1) : r * (q + 1) + (xcd - r) * q) + off; }
        const int nig = WGM * nN, gid = wgid / nig, fm = gid * WGM, gsz = (nM - fm) < WGM ? (nM - fm) : WGM;
        u.pm = fm + ((wgid % nig) % gsz); u.pn = (wgid % nig) / gsz; return true;
    }
    __device__ __forceinline__ void a_ready(const Unit&) const {}
    __device__ __forceinline__ void done(const Unit&) const {}
};
__device__ __forceinline__ unsigned cvt_pk_bf16(float lo, float hi) { unsigned r; asm volatile("v_cvt_pk_bf16_f32 %0, %1, %2" : "=v"(r) : "v"(lo), "v"(hi)); return r; }
typedef float f32x2 __attribute__((ext_vector_type(2)));
__device__ __forceinline__ float gelu_tanh_f(float x) {
    const float u = x * (0.7978845608f + 0.0356774081f * x * x);
    const float e = __builtin_amdgcn_exp2f(-2.885390082f * u);
    return x * __builtin_amdgcn_rcpf(1.0f + e);
}
template <int ACT  > struct EpiBf16 {
    static constexpr bool PERM = true, AFTER_DRAIN = false;
    bf16_t* O0; bf16_t* O1; int ldc; int split_cols;
    __device__ __forceinline__ void operator()(const f32x4 (&acc)[2][2][4][2], const Unit& u, int wr, int wc, int fr, int fq) const {
        const int row0 = u.pm * BM + wr * 64 + fr; int colt = u.pn * BM; bf16_t* base = O0;
        if (split_cols && colt >= split_cols) { base = O1; colt -= split_cols; }
        const int col0 = colt + wc * 32 + 8 * fq;
#pragma unroll
        for (int ai = 0; ai < 2; ++ai)
#pragma unroll
            for (int m = 0; m < 4; ++m) { bf16_t* rowp = base + (size_t)(row0 + ai * HALF + m * 16) * ldc + col0;
#pragma unroll
                for (int bj = 0; bj < 2; ++bj) { f32x4 v0 = acc[ai][bj][m][0], v1 = acc[ai][bj][m][1];
                    if (ACT == 1) {
#pragma unroll
                        for (int j = 0; j < 4; ++j) { v0[j] = gelu_tanh_f(v0[j]); v1[j] = gelu_tanh_f(v1[j]); } }
                    if (ACT == 2) {
#pragma unroll
                        for (int j = 0; j < 4; ++j) { const float a = fmaxf(v0[j], 0.f), b = fmaxf(v1[j], 0.f); v0[j] = a * a; v1[j] = b * b; } }
                    u32x4 w; w.x = cvt_pk_bf16(v0[0], v0[1]); w.y = cvt_pk_bf16(v0[2], v0[3]); w.z = cvt_pk_bf16(v1[0], v1[1]); w.w = cvt_pk_bf16(v1[2], v1[3]);
                    *(u32x4*)(rowp + bj * HALF) = w; } }
    }
};
struct EpiResF32 {
    static constexpr bool PERM = false, AFTER_DRAIN = false;
    const float* resid; float* out; int ldc; float alpha;
    __device__ __forceinline__ void operator()(const f32x4 (&acc)[2][2][4][2], const Unit& u, int wr, int wc, int fr, int fq) const {
        const int row0 = u.pm * BM + wr * 64 + fr, col0 = u.pn * BM + wc * 32 + 4 * fq;
#pragma unroll
        for (int ai = 0; ai < 2; ++ai)
#pragma unroll
            for (int m = 0; m < 4; ++m) { const size_t off = (size_t)(row0 + ai * HALF + m * 16) * ldc + col0;
#pragma unroll
                for (int bj = 0; bj < 2; ++bj)
#pragma unroll
                    for (int n = 0; n < 2; ++n) { const f32x4 r = *(const f32x4*)(resid + off + bj * HALF + n * 16); *(f32x4*)(out + off + bj * HALF + n * 16) = r * alpha + acc[ai][bj][m][n]; }
                if (m & 1) asm volatile("" ::: "memory"); }
    }
};
template <class Epi, class Sched, bool ALIGN_EPI = false, bool SP2 = false>
__device__ __forceinline__ void gemm_phase(PG8_LAS unsigned char* lds, const Gemm g, const Sched& S, const Epi& E) {
    int tid_ = threadIdx.x; asm volatile("" : "+v"(tid_)); const int tid = tid_, wid = __builtin_amdgcn_readfirstlane(tid >> 6), lane = tid & 63, wr = wid >> 2, wc = wid & 3, fr = lane & 15, fq = lane >> 4;
    const int K = g.K, nt = K / BK;
    unsigned voffA[2], voffB[2];
#pragma unroll
    for (int i = 0; i < 2; ++i) { int R, C; stage_rc(tid * 16 + i * 8192, R, C); const int Rb = Epi::PERM ? ((R & ~31) + perm32(R & 31)) : R;
        voffA[i] = (unsigned)(R * K + C) * 2u; voffB[i] = (unsigned)(Rb * K + C) * 2u; }
    const size_t kstep = (size_t)(BK * 2);
    const size_t hstep = (size_t)HALF * K * 2;
    const size_t tstep = 2 * hstep;
    const unsigned ldsw = (unsigned)wid * 1024u;
    const int aoff = lds_byte(wr * 64 + fr, fq * 8), boff = lds_byte(wc * 32 + fr, fq * 8);
#define PG8_SA(b, h) (((b) * 2 + (h)) * HTB)
#define PG8_SB(b, h) ((4 + (b) * 2 + (h)) * HTB)
#define PG8_STAGE(bufoff, gbase, voff) do { _Pragma("unroll") for (int _i = 0; _i < 2; ++_i) \
        __builtin_amdgcn_global_load_lds((const unsigned*)((const char*)(gbase) + (voff)[_i]), (PG8_LAS unsigned*)(lds + (bufoff) + ldsw + _i * 8192), 16, 0, 0); } while (0)
#define PG8_LDA(dst, b, h) do { _Pragma("unroll") for (int m = 0; m < 4; ++m) _Pragma("unroll") for (int k = 0; k < 2; ++k) dst[m][k] = *(const PG8_LAS bf16x8*)(lds + PG8_SA(b, h) + aoff + m * 2048 + k * 1024); } while (0)
#define PG8_LDB(dst, b, h) do { _Pragma("unroll") for (int n = 0; n < 2; ++n) _Pragma("unroll") for (int k = 0; k < 2; ++k) dst[n][k] = *(const PG8_LAS bf16x8*)(lds + PG8_SB(b, h) + boff + n * 2048 + k * 1024); } while (0)
#define PG8_MMA(ai, bj, At, Bt) do { __builtin_amdgcn_s_setprio(1); _Pragma("unroll") for (int m = 0; m < 4; ++m) _Pragma("unroll") for (int n = 0; n < 2; ++n) _Pragma("unroll") for (int k = 0; k < 2; ++k) \
        acc[ai][bj][m][n] = __builtin_amdgcn_mfma_f32_16x16x32_bf16(Bt[n][k], At[m][k], acc[ai][bj][m][n], 0, 0, 0); __builtin_amdgcn_s_setprio(0); } while (0)
#define PG8_WAIT_V(n) asm volatile("s_waitcnt vmcnt(" #n ")" ::: "memory")
#define PG8_WAIT_L(n) asm volatile("s_waitcnt lgkmcnt(" #n ")" ::: "memory")
#define PG8_BAR __builtin_amdgcn_s_barrier()
#define PG8_SCHED __builtin_amdgcn_sched_barrier(0)
    Unit cur, nxt; int ui = 0;
    if (!S.next(0, cur)) return;
    f32x4 acc[2][2][4][2];
#pragma unroll
    for (int a = 0; a < 2; ++a)
#pragma unroll
        for (int b = 0; b < 2; ++b)
#pragma unroll
            for (int m = 0; m < 4; ++m)
#pragma unroll
                for (int n = 0; n < 2; ++n) acc[a][b][m][n] = (f32x4){0.f, 0.f, 0.f, 0.f};
    bf16x8 At[4][2], B0[2][2], B1[2][2];
    const char* cA = (const char*)g.A + (size_t)cur.pm * tstep; const char* cB = (const char*)g.Bt + (size_t)cur.pn * tstep;
    S.a_ready(cur);
    if constexpr (SP2) {
        PG8_STAGE(PG8_SB(0, 0), cB, voffB); PG8_STAGE(PG8_SB(0, 1), cB + hstep, voffB); PG8_STAGE(PG8_SA(0, 0), cA, voffA); PG8_STAGE(PG8_SA(0, 1), cA + hstep, voffA);
        if (wr == 1) PG8_BAR;
        PG8_WAIT_V(2); PG8_BAR;
        PG8_STAGE(PG8_SB(1, 0), cB + kstep, voffB); PG8_STAGE(PG8_SA(1, 0), cA + kstep, voffA); PG8_STAGE(PG8_SB(1, 1), cB + hstep + kstep, voffB);
        PG8_WAIT_V(6); PG8_BAR;
    } else {
        PG8_STAGE(PG8_SB(0, 0), cB, voffB); PG8_STAGE(PG8_SA(0, 0), cA, voffA); PG8_STAGE(PG8_SB(0, 1), cB + hstep, voffB); PG8_STAGE(PG8_SA(0, 1), cA + hstep, voffA);
        if (wr == 1) PG8_BAR;
        PG8_WAIT_V(4); PG8_BAR;
        PG8_STAGE(PG8_SB(1, 0), cB + kstep, voffB); PG8_STAGE(PG8_SA(1, 0), cA + kstep, voffA); PG8_STAGE(PG8_SB(1, 1), cB + hstep + kstep, voffB);
        PG8_WAIT_V(6); PG8_BAR;
    }
    for (;;) {
        const bool has_next = S.next(ui + 1, nxt);
        const char* nA = has_next ? (const char*)g.A + (size_t)nxt.pm * tstep : cA; const char* nB = has_next ? (const char*)g.Bt + (size_t)nxt.pn * tstep : cB;
        for (int t = 0; t < nt; t += 2) {
            const bool last = (t == nt - 2);
            const char* a1 = cA + (size_t)(t + 1) * kstep;
            const char* a2 = last ? nA : cA + (size_t)(t + 2) * kstep; const char* b2 = last ? nB : cB + (size_t)(t + 2) * kstep;
            const char* a3 = a2 + kstep; const char* b3 = b2 + kstep;
            if (last && has_next) S.a_ready(nxt);
            if constexpr (SP2) {
            PG8_LDB(B0, 0, 0); PG8_LDB(B1, 0, 1); PG8_SCHED; PG8_LDA(At, 0, 0); PG8_STAGE(PG8_SA(1, 1), a1 + hstep, voffA);
            PG8_WAIT_V(8); PG8_WAIT_L(0); PG8_BAR; PG8_MMA(0, 0, At, B0); PG8_MMA(0, 1, At, B1); PG8_BAR; PG8_SCHED;
            PG8_LDA(At, 0, 1); PG8_STAGE(PG8_SB(0, 0), b2, voffB); PG8_STAGE(PG8_SB(0, 1), b2 + hstep, voffB); PG8_STAGE(PG8_SA(0, 0), a2, voffA);
            PG8_WAIT_V(8); PG8_WAIT_L(0); PG8_BAR; PG8_MMA(1, 0, At, B0); PG8_MMA(1, 1, At, B1); PG8_BAR; PG8_SCHED;
            PG8_LDB(B0, 1, 0); PG8_LDB(B1, 1, 1); PG8_SCHED; PG8_LDA(At, 1, 0); PG8_STAGE(PG8_SA(0, 1), a2 + hstep, voffA);
            PG8_WAIT_V(8); PG8_WAIT_L(0); PG8_BAR; PG8_MMA(0, 0, At, B0); PG8_MMA(0, 1, At, B1); PG8_BAR; PG8_SCHED;
            PG8_LDA(At, 1, 1); PG8_STAGE(PG8_SB(1, 0), b3, voffB); PG8_STAGE(PG8_SB(1, 1), b3 + hstep, voffB); PG8_STAGE(PG8_SA(1, 0), a3, voffA);
            PG8_WAIT_V(8); PG8_WAIT_L(0); PG8_BAR; PG8_MMA(1, 0, At, B0); PG8_MMA(1, 1, At, B1); PG8_BAR; PG8_SCHED;
            } else {
            PG8_LDB(B0, 0, 0); PG8_SCHED; PG8_LDA(At, 0, 0); PG8_STAGE(PG8_SA(1, 1), a1 + hstep, voffA);
            PG8_WAIT_L(8); PG8_BAR; PG8_WAIT_L(0); PG8_MMA(0, 0, At, B0); PG8_BAR; PG8_SCHED;
            PG8_LDB(B1, 0, 1); PG8_STAGE(PG8_SB(0, 0), b2, voffB);
            PG8_BAR; PG8_WAIT_L(0); PG8_MMA(0, 1, At, B1); PG8_BAR;
            PG8_LDA(At, 0, 1); PG8_STAGE(PG8_SA(0, 0), a2, voffA);
            PG8_BAR; PG8_WAIT_L(0); PG8_MMA(1, 0, At, B0); PG8_BAR; PG8_SCHED;
            PG8_STAGE(PG8_SB(0, 1), b2 + hstep, voffB);
            PG8_WAIT_V(6); PG8_BAR; PG8_MMA(1, 1, At, B1); PG8_BAR;
            PG8_LDB(B0, 1, 0); PG8_SCHED; PG8_LDA(At, 1, 0); PG8_STAGE(PG8_SA(0, 1), a2 + hstep, voffA);
            PG8_WAIT_L(8); PG8_BAR; PG8_WAIT_L(0); PG8_MMA(0, 0, At, B0); PG8_BAR; PG8_SCHED;
            PG8_LDB(B1, 1, 1); PG8_STAGE(PG8_SB(1, 0), b3, voffB);
            PG8_BAR; PG8_WAIT_L(0); PG8_MMA(0, 1, At, B1); PG8_BAR;
            PG8_LDA(At, 1, 1); PG8_STAGE(PG8_SA(1, 0), a3, voffA);
            PG8_BAR; PG8_WAIT_L(0); PG8_MMA(1, 0, At, B0); PG8_BAR; PG8_SCHED;
            PG8_STAGE(PG8_SB(1, 1), b3 + hstep, voffB);
            PG8_WAIT_V(6); PG8_BAR; PG8_MMA(1, 1, At, B1); PG8_BAR;
            }
        }
        if constexpr (ALIGN_EPI) { if (wr == 0) PG8_BAR; }
        if constexpr (!Epi::AFTER_DRAIN) { E(acc, cur, wr, wc, fr, fq); S.done(cur); }
        if (!has_next) break;
#pragma unroll
        for (int a = 0; a < 2; ++a)
#pragma unroll
            for (int b = 0; b < 2; ++b)
#pragma unroll
                for (int m = 0; m < 4; ++m)
#pragma unroll
                    for (int n = 0; n < 2; ++n) acc[a][b][m][n] = (f32x4){0.f, 0.f, 0.f, 0.f};
        cur = nxt; cA = nA; cB = nB; ++ui;
        if constexpr (ALIGN_EPI) { if (wr == 1) PG8_BAR; }
    }
    PG8_WAIT_V(0);
    if constexpr (!ALIGN_EPI) { if (wr == 0) PG8_BAR; }
    PG8_BAR;
    if constexpr (Epi::AFTER_DRAIN) { E.fused(acc, cur, wr, wc, fr, fq, lds, wid, lane); S.done(cur); }
#undef PG8_SA
#undef PG8_SB
#undef PG8_STAGE
#undef PG8_LDA
#undef PG8_LDB
#undef PG8_MMA
#undef PG8_WAIT_V
#undef PG8_WAIT_L
#undef PG8_BAR
#undef PG8_SCHED
}
}
#define GAS __attribute__((address_space(1)))
#define LAS __attribute__((address_space(3)))
typedef unsigned short bf16;
typedef unsigned v4u __attribute__((ext_vector_type(4)));
typedef float f32x4 __attribute__((ext_vector_type(4)));
typedef short bf16x8 __attribute__((ext_vector_type(8)));
typedef GAS unsigned gu32;
typedef GAS unsigned long long gu64;
#define RLX_AGENT __ATOMIC_RELAXED, __HIP_MEMORY_SCOPE_AGENT
#define LDS_WAIT() asm volatile("s_waitcnt lgkmcnt(0)" ::: "memory")
#define VM_WAIT() asm volatile("s_waitcnt vmcnt(0)" ::: "memory")
__device__ __forceinline__ unsigned long long rt() { return __builtin_amdgcn_s_memrealtime(); }
__device__ __forceinline__ unsigned f2bf(float f) { unsigned u = __builtin_bit_cast(unsigned, f); return (u + 0x7fffu + ((u >> 16) & 1u)) >> 16; }
__device__ __forceinline__ unsigned pk2(float lo, float hi) { return f2bf(lo) | (f2bf(hi) << 16); }
#define XB_TMO      128
#define XB_XCNT(j)  (256  + 64 * (j))
#define XB_XSUB(j)  (1280 + 64 * (j))
#define XB_XGEN(j)  (2304 + 64 * (j))
#define XB_TOP      3328
#define XB_TOPGEN   3392
#define XCD_BAR_WORDS 3456
#define XB_SPIN_CAP (1u << 18)

__device__ __forceinline__ unsigned xb_ld(unsigned* p)              { return __hip_atomic_load(p, __ATOMIC_RELAXED, __HIP_MEMORY_SCOPE_AGENT); }
__device__ __forceinline__ unsigned xb_add(unsigned* p, unsigned v) { return __hip_atomic_fetch_add(p, v, __ATOMIC_RELAXED, __HIP_MEMORY_SCOPE_AGENT); }
__device__ __forceinline__ unsigned xb_xcc_id() { return (unsigned)__builtin_amdgcn_s_getreg((3 << 11) | 20) & 0xFu; }
#define XB_SPIN(cond, bar) do { unsigned _sp = 0; while (cond) { __builtin_amdgcn_s_sleep(1); \
    if ((++_sp & 255u) == 0u) { if (xb_ld(&(bar)[XB_TMO])) break; if (_sp > XB_SPIN_CAP) { atomicAdd(&(bar)[XB_TMO], 1u); break; } } } } while (0)

struct XcdBarrier {
    unsigned* bar; unsigned x;
    volatile LAS unsigned* st;
};

__device__ __forceinline__ XcdBarrier xcd_barrier_post(unsigned* bar, volatile LAS unsigned* st) {
    XcdBarrier b; b.bar = bar; b.x = xb_xcc_id(); b.st = st;
    if (threadIdx.x == 0) (void)xb_add(&bar[XB_XCNT(b.x)], 1u);
    return b;
}
__device__ __forceinline__ void xcd_barrier_complete(unsigned* bar, unsigned x, unsigned& nloc, unsigned& nx) {
    const unsigned G = gridDim.x * gridDim.y * gridDim.z;
    unsigned sum, cnt, mine, sp = 0u;
    for (;;) {
        sum = 0u; cnt = 0u; mine = 0u;
#pragma unroll
        for (unsigned j = 0; j < 16; ++j) { const unsigned c = xb_ld(&bar[XB_XCNT(j)]); sum += c; cnt += (c > 0u) ? 1u : 0u; mine = (j == x) ? c : mine; }
        if (sum == G) break;
        __builtin_amdgcn_s_sleep(1);
        if ((++sp & 255u) == 0u) { if (xb_ld(&bar[XB_TMO])) break; if (sp > XB_SPIN_CAP) { atomicAdd(&bar[XB_TMO], 1u); break; } }
    }
    nloc = mine > 0u ? mine : 1u; nx = cnt > 0u ? cnt : 1u;
}

__device__ __forceinline__ void xcd_barrier(const XcdBarrier& b) {
    asm volatile("s_waitcnt vmcnt(0)" ::: "memory");
    __syncthreads();
    if (threadIdx.x == 0) {
        unsigned* bar = b.bar;
        __builtin_amdgcn_s_waitcnt(0);
        unsigned nloc = b.st[0], nx = b.st[1];
        if (nloc == 0u) { xcd_barrier_complete(bar, b.x, nloc, nx); b.st[0] = nloc; b.st[1] = nx; }
        const unsigned old = xb_add(&bar[XB_XSUB(b.x)], 1u);
        const unsigned gen = old / nloc;
        if (old + 1u == (gen + 1u) * nloc) {
            __builtin_amdgcn_fence(__ATOMIC_RELEASE, "agent");
            asm volatile("s_waitcnt vmcnt(0)" ::: "memory");
            const unsigned og = xb_add(&bar[XB_TOP], 1u);
            const unsigned tg = og / nx;
            if (og + 1u == (tg + 1u) * nx) xb_add(&bar[XB_TOPGEN], 1u);
            else XB_SPIN(xb_ld(&bar[XB_TOPGEN]) == tg, bar);
            __builtin_amdgcn_fence(__ATOMIC_ACQUIRE, "agent");
            xb_add(&bar[XB_XGEN(b.x)], 1u);
            asm volatile("s_waitcnt vmcnt(0)" ::: "memory");
        } else {
            XB_SPIN(xb_ld(&bar[XB_XGEN(b.x)]) == gen, bar);
            __builtin_amdgcn_fence(__ATOMIC_ACQUIRE, "agent");
            asm volatile("s_waitcnt vmcnt(0)" ::: "memory");
        }
    }
    __syncthreads();
}
__device__ __forceinline__ float wave_sum(float v) {
#pragma unroll
    for (int o = 1; o < 64; o <<= 1) v += __shfl_xor(v, o);
    return v;
}
__device__ __forceinline__ void p0_transpose_item(const float* W, int K, int N, bf16* WT, int row_off, LAS float* scr, int item, int lane) {
    const int nblk = N / 32, kb = item / nblk, nb = item % nblk, k0 = 64 * kb, n0 = 32 * nb;
#pragma unroll 8
    for (int i = 0; i < 32; ++i) { const int kk = 2 * i + (lane >> 5); scr[kk * 33 + (lane & 31)] = W[(size_t)(k0 + kk) * N + n0 + (lane & 31)]; }
    LDS_WAIT(); asm volatile("" ::: "memory");
    const int c = lane & 7;
#pragma unroll
    for (int j = 0; j < 4; ++j) { const int n = (lane >> 3) + 8 * j; const LAS float* s = scr + (8 * c) * 33 + n;
        v4u o; o.x = pk2(s[0 * 33], s[1 * 33]); o.y = pk2(s[2 * 33], s[3 * 33]); o.z = pk2(s[4 * 33], s[5 * 33]); o.w = pk2(s[6 * 33], s[7 * 33]);
        *(GAS v4u*)(WT + (size_t)(row_off + n0 + n) * K + k0 + 8 * c) = o; }
    LDS_WAIT(); asm volatile("" ::: "memory");
}
constexpr int BATCH = 8, SEQ = 4096, D = 1024, FF = 4096, NH = 16, HD = 64;
constexpr int M = BATCH * SEQ;
constexpr float LN_EPS = 1e-5f;
constexpr float ALPHA = 1.6817928305074292f;
constexpr int NWAVES = 8;
constexpr float LOG2E = 1.4426950408889634f, LN2 = 0.6931471805599453f;
constexpr float EXIT_T = 110.0f;

constexpr size_t MiB = 1u << 20;
constexpr size_t WS_CTL = 0, CTL_ZERO_BYTES = 64 * 1024;
constexpr size_t WS_W = 1 * MiB;
constexpr size_t WS_WSB = 45 * MiB;
constexpr size_t WS_XB = 46 * MiB;
constexpr size_t WS_H = 110 * MiB;
constexpr size_t WS_GK = 366 * MiB;
constexpr size_t WS_VT = 430 * MiB;
constexpr size_t WS_END = 494 * MiB;
constexpr size_t MEL = 1u << 20;
constexpr int CW_BAR = 4096;

constexpr int RING_OFF = 0, RING_BYTES = 131072;
constexpr int LDSCTL_OFF = RING_BYTES, MISC_OFF = LDSCTL_OFF + 320;
constexpr int LDS_BYTES = 147456;

typedef unsigned u32x2_t __attribute__((ext_vector_type(2)));
typedef float f32x16 __attribute__((ext_vector_type(16)));
typedef float f32x2_t __attribute__((ext_vector_type(2)));

__device__ __forceinline__ float bf_lo(unsigned w) { return __builtin_bit_cast(float, w << 16); }
__device__ __forceinline__ float bf_hi(unsigned w) { return __builtin_bit_cast(float, w & 0xffff0000u); }
__device__ __forceinline__ unsigned cvtpk(float lo, float hi) { return pg8::cvt_pk_bf16(lo, hi); }

struct Frame { LAS unsigned char* lds; };
#define PHASE_IDS() int tid = threadIdx.x; asm volatile("" : "+v"(tid)); const int lane = tid & 63; const int wave = __builtin_amdgcn_readfirstlane(tid >> 6); \
    int bx_ = blockIdx.x; asm volatile("" : "+s"(bx_)); const int G_ = gridDim.x; const int vcu = (G_ % 8 == 0) ? (bx_ % 8) * (G_ / 8) + bx_ / 8 : bx_; (void)lane; (void)wave; (void)vcu; (void)tid

__device__ __forceinline__ void conv_T(Frame& F, LAS float* scr, const float* W, int K, int N, bf16* WT, int& base_item, int nitems_total_hint) {
    (void)nitems_total_hint;
    PHASE_IDS();
    const int gw = vcu * NWAVES + wave, NGW = G_ * NWAVES;
    const int items = (K / 64) * (N / 32);
    int it = (gw - (base_item % NGW) + NGW) % NGW;
    for (; it < items; it += NGW) p0_transpose_item(W, K, N, WT, 0, scr, it, lane);
    base_item += items;
}

__device__ __forceinline__ void ln_row(int lane, float* row, const float* g, const float* b, bf16* orow) {
    GAS f32x4* xr = (GAS f32x4*)row + lane;
    f32x4 v[4]; float s = 0.f;
#pragma unroll
    for (int j = 0; j < 4; ++j) { v[j] = xr[64 * j]; s += (v[j].x + v[j].y) + (v[j].z + v[j].w); }
    const float mean = wave_sum(s) * (1.f / D); float s2 = 0.f;
#pragma unroll
    for (int j = 0; j < 4; ++j) { v[j] = v[j] - mean; s2 += (v[j].x * v[j].x + v[j].y * v[j].y) + (v[j].z * v[j].z + v[j].w * v[j].w); }
    const float rstd = 1.f / sqrtf(wave_sum(s2) * (1.f / D) + LN_EPS);
    GAS u32x2_t* o8 = (GAS u32x2_t*)orow + lane;
#pragma unroll
    for (int j = 0; j < 4; ++j) {
        const f32x4 gg = *((const GAS f32x4*)g + lane + 64 * j), bb = *((const GAS f32x4*)b + lane + 64 * j);
        const f32x4 y = v[j] * rstd * gg + bb;
        xr[64 * j] = y;
        u32x2_t w; w.x = cvtpk(y.x, y.y); w.y = cvtpk(y.z, y.w); o8[64 * j] = w;
    }
}
__device__ __forceinline__ void ln_phase(Frame& F, float* buf, const float* g, const float* b, bf16* XB) {
    PHASE_IDS();
    const int gw = vcu * NWAVES + wave, NGW = G_ * NWAVES;
    for (int m = gw; m < M; m += NGW) ln_row(lane, buf + (size_t)m * D, g, b, XB + (size_t)m * D);
}

__device__ __forceinline__ void gating_phase(Frame& F, const bf16* U, const bf16* VhT, const bf16* Wsb, const float* lng, const float* lnb, const float* bsl, bf16* Gt) {
    LAS float* part = (LAS float*)(F.lds);
    LAS float* stat = (LAS float*)(F.lds + 8192);
    PHASE_IDS();
    const int g = wave, j = lane & 31, hi = lane >> 5;
    for (int nb = vcu; nb < M / 128; nb += G_) {
        const int tok0 = nb * 128;
        {
            float s0 = 0.f, s1 = 0.f, q0 = 0.f, q1 = 0.f;
            const bf16* vp = VhT + (size_t)(128 * g) * M + tok0 + 2 * lane;
#pragma unroll 8
            for (int c = 0; c < 128; ++c) { const unsigned w = *(const GAS unsigned*)(vp + (size_t)c * M); const float a = bf_lo(w), b = bf_hi(w); s0 += a; q0 += a * a; s1 += b; q1 += b * b; }
            part[(g * 128 + 2 * lane) * 2 + 0] = s0; part[(g * 128 + 2 * lane) * 2 + 1] = q0;
            part[(g * 128 + 2 * lane + 1) * 2 + 0] = s1; part[(g * 128 + 2 * lane + 1) * 2 + 1] = q1;
        }
        __syncthreads();
        if (tid < 128) { float s = 0.f, q = 0.f;
#pragma unroll
            for (int w = 0; w < 8; ++w) { s += part[(w * 128 + tid) * 2]; q += part[(w * 128 + tid) * 2 + 1]; }
            const float mean = s * (1.f / D); const float var = fmaxf(q * (1.f / D) - mean * mean, 0.f);
            stat[tid * 2] = mean; stat[tid * 2 + 1] = 1.f / sqrtf(var + LN_EPS); }
        __syncthreads();
        const bf16* wsg = Wsb + (size_t)g * 128 * 128;
#pragma unroll 1
        for (int ct = 0; ct < 4; ++ct) {
            const int c = 128 * g + 32 * ct + j;
            const float gl = lng[c], bl = lnb[c];
            const bf16* vrow = VhT + (size_t)c * M + tok0 + 8 * hi;
            pg8::bf16x8 af[8];
#pragma unroll
            for (int kk = 0; kk < 8; ++kk) {
                const v4u raw = *(const GAS v4u*)(vrow + 16 * kk);
                const LAS f32x4* sp = (const LAS f32x4*)(stat + (16 * kk + 8 * hi) * 2);
                const f32x4 p0 = sp[0], p1 = sp[1], p2 = sp[2], p3 = sp[3];
                const float y0 = (bf_lo(raw.x) - p0.x) * p0.y * gl + bl, y1 = (bf_hi(raw.x) - p0.z) * p0.w * gl + bl;
                const float y2 = (bf_lo(raw.y) - p1.x) * p1.y * gl + bl, y3 = (bf_hi(raw.y) - p1.z) * p1.w * gl + bl;
                const float y4 = (bf_lo(raw.z) - p2.x) * p2.y * gl + bl, y5 = (bf_hi(raw.z) - p2.z) * p2.w * gl + bl;
                const float y6 = (bf_lo(raw.w) - p3.x) * p3.y * gl + bl, y7 = (bf_hi(raw.w) - p3.z) * p3.w * gl + bl;
                v4u pk; pk.x = cvtpk(y0, y1); pk.y = cvtpk(y2, y3); pk.z = cvtpk(y4, y5); pk.w = cvtpk(y6, y7);
                af[kk] = __builtin_bit_cast(pg8::bf16x8, pk);
            }
#pragma unroll
            for (int tt = 0; tt < 4; ++tt) {
                f32x16 acc;
#pragma unroll
                for (int r = 0; r < 16; ++r) acc[r] = 0.f;
                const bf16* wrow = wsg + (size_t)(32 * tt + j) * 128 + 8 * hi;
#pragma unroll
                for (int kk = 0; kk < 8; ++kk) if (tt >= 2 || kk < 4) {
                    const pg8::bf16x8 bfrag = *(const GAS pg8::bf16x8*)(wrow + 16 * kk);
                    acc = __builtin_amdgcn_mfma_f32_32x32x16_bf16(af[kk], bfrag, acc, 0, 0, 0);
                }
                const int t = 32 * tt + j; const float bs = bsl[g * 128 + t];
                const size_t rowoff = (size_t)(tok0 + t) * D + 128 * g + 32 * ct + 4 * hi;
#pragma unroll
                for (int q = 0; q < 4; ++q) {
                    const u32x2_t uw = *(const GAS u32x2_t*)(U + rowoff + 8 * q);
                    const float o0 = bf_lo(uw.x) * (acc[4 * q + 0] + bs), o1 = bf_hi(uw.x) * (acc[4 * q + 1] + bs);
                    const float o2 = bf_lo(uw.y) * (acc[4 * q + 2] + bs), o3 = bf_hi(uw.y) * (acc[4 * q + 3] + bs);
                    u32x2_t ow; ow.x = cvtpk(o0, o1); ow.y = cvtpk(o2, o3);
                    *(GAS u32x2_t*)(Gt + rowoff + 8 * q) = ow;
                }
            }
        }
        __syncthreads();
    }
}

__device__ __forceinline__ void sb_attn_phase(Frame& F, const bf16* Q, const bf16* Kb, const bf16* VT, bf16* O) {
    PHASE_IDS();
    const int j = lane & 31, hi = lane >> 5;
    const int gw = vcu * NWAVES + wave, NGW = G_ * NWAVES;
    constexpr int NQT = SEQ / 32, NUNIT = BATCH * NH * NQT;
#pragma unroll 1
    for (int unit = gw; unit < NUNIT; unit += NGW) {
        const int qt = unit % NQT, bh = unit / NQT, h = bh % NH, b = bh / NH;
        const int seq0 = b * SEQ, q0 = qt * 32, tpos = q0 + j;
        pg8::bf16x8 qf[4];
        { const bf16* qrow = Q + (size_t)(seq0 + q0 + j) * D + h * HD + 8 * hi;
#pragma unroll
          for (int kk = 0; kk < 4; ++kk) qf[kk] = *(const GAS pg8::bf16x8*)(qrow + 16 * kk); }
        f32x16 o0, o1;
#pragma unroll
        for (int r = 0; r < 16; ++r) { o0[r] = 0.f; o1[r] = 0.f; }
        float R = 0.f;
#pragma unroll 1
        for (int kb = q0; kb >= 0; kb -= 32) {
            f32x16 s;
#pragma unroll
            for (int r = 0; r < 16; ++r) s[r] = 0.f;
            { const bf16* krow = Kb + (size_t)(seq0 + kb + j) * D + h * HD + 8 * hi;
#pragma unroll
              for (int kk = 0; kk < 4; ++kk) { const pg8::bf16x8 kf = *(const GAS pg8::bf16x8*)(krow + 16 * kk); s = __builtin_amdgcn_mfma_f32_32x32x16_bf16(kf, qf[kk], s, 0, 0, 0); } }
            pg8::bf16x8 vf[2][2];
#pragma unroll
            for (int dt = 0; dt < 2; ++dt)
#pragma unroll
                for (int s2 = 0; s2 < 2; ++s2) {
                    const bf16* vp = VT + (size_t)(h * HD + dt * 32 + j) * M + seq0 + kb + 16 * s2 + 4 * hi;
                    const u32x2_t a = *(const GAS u32x2_t*)(vp), c = *(const GAS u32x2_t*)(vp + 8);
                    v4u pk; pk.x = a.x; pk.y = a.y; pk.z = c.x; pk.w = c.y; vf[dt][s2] = __builtin_bit_cast(pg8::bf16x8, pk);
                }
            float lr[16], lsp[16];
#pragma unroll
            for (int r = 0; r < 16; ++r) {
                const int key = kb + (r & 3) + 8 * (r >> 2) + 4 * hi;
                const float z = s[r] * 0.125f;
                const float e = __builtin_amdgcn_exp2f(-fabsf(z) * LOG2E);
                const float L = __builtin_amdgcn_logf(1.0f + e) * LN2;
                lsp[r] = fminf(z, 0.f) - L;
                lr[r] = (key < tpos) ? (lsp[r] - z) : 0.f;
            }
            float G4[4], Gp[4];
#pragma unroll
            for (int g = 0; g < 4; ++g) { G4[g] = (lr[4 * g] + lr[4 * g + 1]) + (lr[4 * g + 2] + lr[4 * g + 3]); Gp[g] = __shfl_xor(G4[g], 32); }
            float run = R; float a[16];
#pragma unroll
            for (int g = 3; g >= 0; --g) {
                const float base = run + (hi == 0 ? Gp[g] : 0.f);
                const float e3 = base, e2 = e3 + lr[4 * g + 3], e1 = e2 + lr[4 * g + 2], e0 = e1 + lr[4 * g + 1];
                a[4 * g + 3] = e3; a[4 * g + 2] = e2; a[4 * g + 1] = e1; a[4 * g] = e0;
                run += G4[g] + Gp[g];
            }
            R = run;
#pragma unroll
            for (int r = 0; r < 16; ++r) {
                const int key = kb + (r & 3) + 8 * (r >> 2) + 4 * hi;
                const float p = __builtin_amdgcn_exp2f((lsp[r] + a[r]) * LOG2E);
                a[r] = (key < tpos) ? p : 0.f;
            }
#pragma unroll
            for (int s2 = 0; s2 < 2; ++s2) {
                v4u pk; pk.x = cvtpk(a[8 * s2], a[8 * s2 + 1]); pk.y = cvtpk(a[8 * s2 + 2], a[8 * s2 + 3]); pk.z = cvtpk(a[8 * s2 + 4], a[8 * s2 + 5]); pk.w = cvtpk(a[8 * s2 + 6], a[8 * s2 + 7]);
                const pg8::bf16x8 pf = __builtin_bit_cast(pg8::bf16x8, pk);
                o0 = __builtin_amdgcn_mfma_f32_32x32x16_bf16(vf[0][s2], pf, o0, 0, 0, 0);
                o1 = __builtin_amdgcn_mfma_f32_32x32x16_bf16(vf[1][s2], pf, o1, 0, 0, 0);
            }
            if (!__any(R >= -EXIT_T)) break;
        }
        bf16* orow = O + (size_t)(seq0 + q0 + j) * D + h * HD + 4 * hi;
#pragma unroll
        for (int q = 0; q < 4; ++q) {
            u32x2_t w0; w0.x = cvtpk(o0[4 * q], o0[4 * q + 1]); w0.y = cvtpk(o0[4 * q + 2], o0[4 * q + 3]);
            u32x2_t w1; w1.x = cvtpk(o1[4 * q], o1[4 * q + 1]); w1.y = cvtpk(o1[4 * q + 2], o1[4 * q + 3]);
            *(GAS u32x2_t*)(orow + 8 * q) = w0; *(GAS u32x2_t*)(orow + 32 + 8 * q) = w1;
        }
    }
}

struct Args { const float* in[17]; float* out; unsigned char* ws; };
enum { I_X = 0, I_WIN, I_LNG, I_LNB, I_WS, I_BS, I_WOUT, I_WK, I_WV, I_WQ, I_WO, I_MG, I_MB, I_FG, I_FB, I_W1, I_W2 };

template <int ACT> __device__ __forceinline__ void gemm_bf16(Frame& F, const bf16* A, const bf16* Bt, int Mr, int Nc, int K, bf16* O0, bf16* O1, int split, int ldc) {
    pg8::Gemm g{A, Bt, Mr, Nc, K}; pg8::StaticOrder S; S.init(Mr, Nc, (int)gridDim.x, (int)blockIdx.x);
    pg8::EpiBf16<ACT> E{O0, O1, ldc, split};
    pg8::gemm_phase<pg8::EpiBf16<ACT>, pg8::StaticOrder, true, true>(F.lds + RING_OFF, g, S, E);
}

__global__ void __launch_bounds__(NWAVES * 64, 2) yoco_fwd(Args args) {
    extern __shared__ __attribute__((aligned(16))) unsigned char lds[];
    Frame F;
    F.lds = (LAS unsigned char*)lds;
    unsigned char* ws = args.ws;
    gu32* ctl = (gu32*)(ws + WS_CTL);
    volatile LAS unsigned* MISC = (volatile LAS unsigned*)(F.lds + MISC_OFF);
    for (int u = threadIdx.x; u < (LDS_BYTES - LDSCTL_OFF) / 4; u += NWAVES * 64) ((LAS unsigned*)(F.lds + LDSCTL_OFF))[u] = 0u;
    __syncthreads();
    XcdBarrier bar = xcd_barrier_post((unsigned*)(ctl + CW_BAR), MISC + 8);
#define GRID_BAR() xcd_barrier(bar)

    const float* x = args.in[I_X]; float* out = args.out;
    bf16* W = (bf16*)(ws + WS_W); bf16* WSB = (bf16*)(ws + WS_WSB); bf16* XB = (bf16*)(ws + WS_XB); bf16* HB = (bf16*)(ws + WS_H);
    bf16* GK = (bf16*)(ws + WS_GK); bf16* VT = (bf16*)(ws + WS_VT);
    bf16* Ub = HB; bf16* VhT = HB + (size_t)M * D;
    bf16* Qb = HB; bf16* Ob = HB + (size_t)M * D;

    {
        PHASE_IDS();
        const int gt = (vcu * NWAVES + wave) * 64 + lane, NGT = G_ * NWAVES * 64;
        LAS float* scr = (LAS float*)(F.lds + RING_OFF + wave * 16384);
        int base = 0;
#pragma unroll 1
        for (int l = 0; l < 2; ++l) {
            bf16* Wl = W + (size_t)l * 11 * MEL;
            conv_T(F, scr, args.in[I_WIN] + (size_t)l * D * 2 * D, D, 2 * D, Wl, base, 0);
            conv_T(F, scr, args.in[I_WOUT] + (size_t)l * D * D, D, D, Wl + 2 * MEL, base, 0);
            conv_T(F, scr, args.in[I_W1] + (size_t)l * D * FF, D, FF, Wl + 3 * MEL, base, 0);
            conv_T(F, scr, args.in[I_W2] + (size_t)l * FF * D, FF, D, Wl + 7 * MEL, base, 0);
        }
        const float* wsrc = args.in[I_WS];
        for (int i = gt; i < 2 * 8 * 128 * 128; i += NGT) { const int s = i & 127, t = (i >> 7) & 127; const float v = ((s >> 6) <= (t >> 6)) ? wsrc[i] : 0.f; WSB[i] = (bf16)(cvtpk(v, 0.f) & 0xffffu); }
        for (size_t i = (size_t)gt; i < (size_t)M * D / 8; i += (size_t)NGT) {
            const f32x4 a = *((const GAS f32x4*)x + 2 * i), c = *((const GAS f32x4*)x + 2 * i + 1);
            v4u w; w.x = cvtpk(a.x, a.y); w.y = cvtpk(a.z, a.w); w.z = cvtpk(c.x, c.y); w.w = cvtpk(c.z, c.w);
            *((GAS v4u*)XB + i) = w;
        }
    }
    cg::this_grid().sync();

#pragma unroll 1
    for (int l = 0; l < 4; ++l) {
        const float* resid = (l == 0) ? x : out;
        const bf16* mixA; const bf16* mixW; const bf16* W1t; const bf16* W2t;
        if (l < 2) {
            bf16* Wl = W + (size_t)l * 11 * MEL;
            gemm_bf16<1>(F, XB, Wl, M, D, D, Ub, Ub, 0, D);
            gemm_bf16<1>(F, Wl + MEL, XB, D, M, D, VhT, VhT, 0, M);
            GRID_BAR();
            gating_phase(F, Ub, VhT, WSB + (size_t)l * 8 * 128 * 128, args.in[I_LNG] + l * D, args.in[I_LNB] + l * D, args.in[I_BS] + l * 8 * 128, GK);
            GRID_BAR();
            mixA = GK; mixW = Wl + 2 * MEL; W1t = Wl + 3 * MEL; W2t = Wl + 7 * MEL;
        } else {
            const int jb = l - 2;
            if (jb == 0) {
                gemm_bf16<0>(F, XB, W, M, 2 * D, D, GK, Qb, D, D);
                gemm_bf16<0>(F, W + 2 * MEL, XB, D, M, D, VT, VT, 0, M);
            } else {
                gemm_bf16<0>(F, XB, W + 3 * MEL, M, D, D, Qb, Qb, 0, D);
            }
            GRID_BAR();
            sb_attn_phase(F, Qb, GK, VT, Ob);
            GRID_BAR();
            mixA = Ob; mixW = W + (4 + jb) * MEL; W1t = W + (6 + 4 * jb) * MEL; W2t = W + (14 + 4 * jb) * MEL;
        }
        {
            pg8::Gemm g{mixA, mixW, M, D, D}; pg8::StaticOrder S; S.init(M, D, (int)gridDim.x, (int)blockIdx.x);
            pg8::EpiResF32 E{resid, out, D, ALPHA};
            pg8::gemm_phase<pg8::EpiResF32, pg8::StaticOrder, true, true>(F.lds + RING_OFF, g, S, E);
        }
        GRID_BAR();
        ln_phase(F, out, args.in[I_MG] + l * D, args.in[I_MB] + l * D, XB);
        GRID_BAR();
        gemm_bf16<2>(F, XB, W1t, M, FF, D, HB, HB, 0, FF);
        GRID_BAR();
        {
            pg8::Gemm g{HB, W2t, M, D, FF}; pg8::StaticOrder S; S.init(M, D, (int)gridDim.x, (int)blockIdx.x);
            pg8::EpiResF32 E{out, out, D, ALPHA};
            pg8::gemm_phase<pg8::EpiResF32, pg8::StaticOrder, true, true>(F.lds + RING_OFF, g, S, E);
        }
        GRID_BAR();
        ln_phase(F, out, args.in[I_FG] + l * D, args.in[I_FB] + l * D, XB);
        if (l == 1) {
            PHASE_IDS();
            LAS float* scr = (LAS float*)(F.lds + RING_OFF + wave * 16384);
            int base = 0;
            conv_T(F, scr, args.in[I_WK], D, D, W, base, 0);
            conv_T(F, scr, args.in[I_WQ], D, D, W + 1 * MEL, base, 0);
            conv_T(F, scr, args.in[I_WV], D, D, W + 2 * MEL, base, 0);
            conv_T(F, scr, args.in[I_WQ] + (size_t)D * D, D, D, W + 3 * MEL, base, 0);
            conv_T(F, scr, args.in[I_WO], D, D, W + 4 * MEL, base, 0);
            conv_T(F, scr, args.in[I_WO] + (size_t)D * D, D, D, W + 5 * MEL, base, 0);
            conv_T(F, scr, args.in[I_W1] + (size_t)2 * D * FF, D, FF, W + 6 * MEL, base, 0);
            conv_T(F, scr, args.in[I_W1] + (size_t)3 * D * FF, D, FF, W + 10 * MEL, base, 0);
            conv_T(F, scr, args.in[I_W2] + (size_t)2 * FF * D, FF, D, W + 14 * MEL, base, 0);
            conv_T(F, scr, args.in[I_W2] + (size_t)3 * FF * D, FF, D, W + 18 * MEL, base, 0);
        }
        if (l < 3) GRID_BAR();
    }
#undef GRID_BAR
}

extern "C" void kernel_launch(void* const* d_in, const int* in_sizes, int n_in, void* d_out, int out_size, void* d_ws, size_t ws_size, hipStream_t stream) {
    static int grid = 0;
    if (grid == 0) {
        if (n_in != 17 || in_sizes[0] != M * D || out_size != M * D || ws_size < WS_END) { fprintf(stderr, "kernel_launch: shape/workspace mismatch (n_in %d, in0 %d, out %d, ws %zu < %zu); nothing launched\n", n_in, n_in > 0 ? in_sizes[0] : -1, out_size, ws_size, (size_t)WS_END); grid = -1; return; }
        int dev = 0, cus = 0, per_cu = 0;
        if (hipGetDevice(&dev) != hipSuccess || hipDeviceGetAttribute(&cus, hipDeviceAttributeMultiprocessorCount, dev) != hipSuccess) { grid = -1; return; }
        if (hipFuncSetAttribute((const void*)yoco_fwd, hipFuncAttributeMaxDynamicSharedMemorySize, LDS_BYTES) != hipSuccess) { fprintf(stderr, "kernel_launch: hipFuncSetAttribute failed\n"); grid = -1; return; }
        if (hipOccupancyMaxActiveBlocksPerMultiprocessor(&per_cu, (const void*)yoco_fwd, NWAVES * 64, LDS_BYTES) != hipSuccess || per_cu < 1) { fprintf(stderr, "kernel_launch: occupancy query says %d\n", per_cu); per_cu = 1; }
        (void)hipGetLastError();
        grid = cus * 1;
    }
    if (grid < 0) return;
    (void)hipMemsetAsync((char*)d_ws + WS_CTL, 0, CTL_ZERO_BYTES, stream);
    Args a{};
    for (int i = 0; i < 17; ++i) a.in[i] = (const float*)d_in[i];
    a.out = (float*)d_out; a.ws = (unsigned char*)d_ws;
    void* kargs[] = {&a};
    hipError_t e = hipLaunchCooperativeKernel((const void*)yoco_fwd, dim3(grid), dim3(NWAVES * 64), kargs, LDS_BYTES, stream);
    if (e != hipSuccess) fprintf(stderr, "kernel_launch: cooperative launch failed: %s (grid %d)\n", hipGetErrorString(e), grid);
}
```
